# Optimizing an MI355X kernel written in HIP

```python
import math
import jax, jax.numpy as jnp
from jax import lax
import numpy as np

D_MODEL = 1024
BATCH = 8
SEQ = 4096
DEPTH = 1

PLE_DIM = 256
HEAD_DIM = 64
A_Q_HEADS = 8
A_KV_HEADS = 2
A_GROUP = A_Q_HEADS // A_KV_HEADS
A_WINDOW = 128
B_HEADS = 8
B_PATTERNS = ((128, 1), (512, 4), (2048, 16))
N_HEADS_TOTAL = A_Q_HEADS + B_HEADS
A_Q = A_Q_HEADS * HEAD_DIM
A_KV = A_KV_HEADS * HEAD_DIM
B_W = B_HEADS * HEAD_DIM
D_IN = A_Q + 2 * A_KV + 3 * B_W
D_MIX = A_Q + B_W
D_FF = 2816
NUM_BUCKETS = 32
MAX_DISTANCE = 2048
BLOCK = 128
EPS = 1e-6
NEG_INF = -1e30

kernel_name = "hymba_swa_sink_dilated_macaron_layer"


def rms_norm(x, g):
    xf = x.astype(jnp.float32)
    y = xf * lax.rsqrt(jnp.mean(xf * xf, axis=-1, keepdims=True) + EPS)
    return (y * g.astype(jnp.float32)).astype(x.dtype)


def swiglu(x, w_gu, w_down):
    g, u = jnp.split(x @ w_gu, 2, axis=-1)
    return (jax.nn.silu(g) * u) @ w_down


def t5_bucket(dist):
    max_exact = NUM_BUCKETS // 2
    n = jnp.maximum(dist, 0)
    nf = jnp.maximum(n, 1).astype(jnp.float32)
    large = max_exact + (jnp.log(nf / max_exact) / math.log(MAX_DISTANCE / max_exact)
                         * (NUM_BUCKETS - max_exact)).astype(jnp.int32)
    large = jnp.minimum(large, NUM_BUCKETS - 1)
    return jnp.where(n < max_exact, n, large)


def banded_attention(q, k, v, rel_bias, max_dist, stride):
    n, L, hkv, grp, dh = q.shape
    bq = math.gcd(L, BLOCK)
    nb = L // bq
    nk = bq + max_dist
    pad = ((0, 0), (max_dist, 0), (0, 0), (0, 0))
    k_pad = jnp.pad(k, pad)
    v_pad = jnp.pad(v, pad)
    key_idx = jnp.arange(nb)[:, None] * bq + jnp.arange(nk)[None, :]
    kb = k_pad[:, key_idx]
    vb = v_pad[:, key_idx]
    qb = q.reshape(n, nb, bq, hkv, grp, dh)
    logits = jnp.einsum('nbqhgd,nbkhd->nbhgqk', qb, kb,
                        preferred_element_type=jnp.float32) * (dh ** -0.5)
    rel = jnp.arange(bq)[:, None] + max_dist - jnp.arange(nk)[None, :]
    bias = rel_bias[t5_bucket(rel * stride)].astype(jnp.float32)
    bias = bias.reshape(bq, nk, hkv, grp).transpose(2, 3, 0, 1)
    in_band = (rel >= 0) & (rel <= max_dist)
    key_pos = key_idx - max_dist
    valid = in_band[None] & (key_pos >= 0)[:, None, :]
    logits = jnp.where(valid[None, :, None, None], logits + bias, NEG_INF)
    m = jnp.max(logits, axis=-1)
    pr = jnp.exp(logits - m[..., None])
    s = jnp.sum(pr, axis=-1)
    o = jnp.einsum('nbhgqk,nbkhd->nbqhgd', pr, vb.astype(jnp.float32))
    o = o.reshape(n, L, hkv, grp, dh)
    m = m.transpose(0, 1, 4, 2, 3).reshape(n, L, hkv, grp)
    s = s.transpose(0, 1, 4, 2, 3).reshape(n, L, hkv, grp)
    return o, m, s


def to_classes(t, r):
    b, s = t.shape[:2]
    rest = t.shape[2:]
    t = jnp.moveaxis(t.reshape((b, s // r, r) + rest), 2, 1)
    return t.reshape((b * r, s // r) + rest)


def from_classes(t, b, r):
    n, L = t.shape[:2]
    rest = t.shape[2:]
    t = jnp.moveaxis(t.reshape((b, r, L) + rest), 1, 2)
    return t.reshape((b, L * r) + rest)


def sink_swa_gqa(q_a, k_a, v_a, sinks, rel_bias_a):
    b, s, _ = q_a.shape
    q = q_a.reshape(b, s, A_KV_HEADS, A_GROUP, HEAD_DIM)
    k = k_a.reshape(b, s, A_KV_HEADS, HEAD_DIM)
    v = v_a.reshape(b, s, A_KV_HEADS, HEAD_DIM)
    o, m, den = banded_attention(q, k, v, rel_bias_a, A_WINDOW - 1, 1)
    sink = sinks.reshape(A_KV_HEADS, A_GROUP).astype(jnp.float32)
    m_all = jnp.maximum(m, sink)
    scale = jnp.exp(m - m_all)
    total = den * scale + jnp.exp(sink - m_all)
    o = o * (scale / total)[..., None]
    return o.reshape(b, s, A_Q)


def dilated_mixture(q_b, k_b, v_b, rel_bias_b):
    b, s, _ = q_b.shape
    q = q_b.reshape(b, s, B_HEADS, 1, HEAD_DIM)
    k = k_b.reshape(b, s, B_HEADS, HEAD_DIM)
    v = v_b.reshape(b, s, B_HEADS, HEAD_DIM)
    outs, maxes, dens = [], [], []
    for window, dil in B_PATTERNS:
        o, m, den = banded_attention(to_classes(q, dil), to_classes(k, dil), to_classes(v, dil),
                                     rel_bias_b, window // dil, dil)
        outs.append(from_classes(o, b, dil))
        maxes.append(from_classes(m, b, dil))
        dens.append(from_classes(den, b, dil))
    m_stack = jnp.stack(maxes)
    m_all = jnp.max(m_stack, axis=0)
    w = jnp.exp(m_stack - m_all)
    num = jnp.sum(w[..., None] * jnp.stack(outs), axis=0)
    den_all = jnp.sum(w * jnp.stack(dens), axis=0)
    return (num / den_all[..., None]).reshape(b, s, B_W)


def setup_inputs(seed: int = 0) -> dict:
    key = jax.random.key(seed)
    ks = jax.random.split(key, 24)
    f32 = jnp.float32

    def w(k, shape, fan_in):
        return jax.random.normal(k, shape, f32) * (fan_in ** -0.5)

    def gain(k, shape):
        return 1.0 + 0.05 * jax.random.normal(k, shape, f32)

    def small(k, shape, scale=0.02):
        return scale * jax.random.normal(k, shape, f32)

    D = D_MODEL
    return {
        "x": jax.random.normal(ks[0], (BATCH, SEQ, D), f32),
        "p": jax.random.normal(ks[1], (DEPTH, BATCH, SEQ, PLE_DIM), f32),
        "rel_bias": small(ks[2], (NUM_BUCKETS, N_HEADS_TOTAL), 0.5),
        "ffn1_pre_g": gain(ks[3], (DEPTH, D)),
        "ffn1_w_gu": w(ks[4], (DEPTH, D, 2 * D_FF), D),
        "ffn1_w_down": w(ks[5], (DEPTH, D_FF, D), D_FF),
        "ffn1_post_g": gain(ks[6], (DEPTH, D)),
        "attn_pre_g": gain(ks[7], (DEPTH, D)),
        "w_in": w(ks[8], (DEPTH, D, D_IN), D),
        "b_in": small(ks[9], (DEPTH, D_IN)),
        "sinks": small(ks[10], (DEPTH, A_Q_HEADS), 0.5),
        "w_out": w(ks[11], (DEPTH, D_MIX, D), D_MIX),
        "b_out": small(ks[12], (DEPTH, D)),
        "attn_post_g": gain(ks[13], (DEPTH, D)),
        "ffn2_pre_g": gain(ks[14], (DEPTH, D)),
        "ffn2_w_gu": w(ks[15], (DEPTH, D, 2 * D_FF), D),
        "ffn2_w_down": w(ks[16], (DEPTH, D_FF, D), D_FF),
        "ffn2_post_g": gain(ks[17], (DEPTH, D)),
        "ple_pre_g": gain(ks[18], (DEPTH, D)),
        "w_ple_gate": w(ks[19], (DEPTH, D, D), D),
        "w_ple_proj": w(ks[20], (DEPTH, PLE_DIM, D), PLE_DIM),
        "ple_post_g": gain(ks[21], (DEPTH, D)),
    }


def reference(x, p, rel_bias, ffn1_pre_g, ffn1_w_gu, ffn1_w_down, ffn1_post_g,
              attn_pre_g, w_in, b_in, sinks, w_out, b_out, attn_post_g,
              ffn2_pre_g, ffn2_w_gu, ffn2_w_down, ffn2_post_g,
              ple_pre_g, w_ple_gate, w_ple_proj, ple_post_g):
    h = x
    splits = [A_Q, A_Q + A_KV, A_Q + 2 * A_KV, A_Q + 2 * A_KV + B_W, A_Q + 2 * A_KV + 2 * B_W]
    for i in range(DEPTH):
        f = swiglu(rms_norm(h, ffn1_pre_g[i]), ffn1_w_gu[i], ffn1_w_down[i])
        h = h + 0.5 * rms_norm(f, ffn1_post_g[i])

        z = rms_norm(h, attn_pre_g[i]) @ w_in[i] + b_in[i]
        q_a, k_a, v_a, q_b, k_b, v_b = jnp.split(z, splits, axis=-1)
        out_a = sink_swa_gqa(q_a, k_a, v_a, sinks[i], rel_bias[:, :A_Q_HEADS])
        out_b = dilated_mixture(q_b, k_b, v_b, rel_bias[:, A_Q_HEADS:])
        mix = jnp.concatenate([out_a, out_b], axis=-1).astype(x.dtype)
        att = mix @ w_out[i] + b_out[i]
        h = h + rms_norm(att, attn_post_g[i])

        f = swiglu(rms_norm(h, ffn2_pre_g[i]), ffn2_w_gu[i], ffn2_w_down[i])
        h = h + 0.5 * rms_norm(f, ffn2_post_g[i])

        gate = jax.nn.sigmoid(rms_norm(h, ple_pre_g[i]) @ w_ple_gate[i])
        e = p[i] @ w_ple_proj[i]
        h = h + rms_norm(gate * e, ple_post_g[i])
    return h
```

```cpp
#include <hip/hip_runtime.h>
#include <cstdio>
#include <cstdint>

namespace cfg {
constexpr int D = 1024, BATCH = 8, SEQ = 4096, M = BATCH * SEQ, PLE = 256, HD = 64;
constexpr int AQ = 512, AKV = 128, BW = 512, DIN = 2304, DMIX = 1024, DFF = 2816, NBUCK = 32, NHT = 16;
constexpr int BT = 2064;
constexpr float EPS = 1e-6f;
}
using namespace cfg;

typedef float f32x4 __attribute__((ext_vector_type(4)));

__device__ __forceinline__ float wave_sum(float v) {
#pragma unroll
    for (int o = 1; o < 64; o <<= 1) v += __shfl_xor(v, o);
    return v;
}

__global__ void sk_bias_table(const float* __restrict__ rel_bias, float* __restrict__ biasT) {
    const int i = blockIdx.x * blockDim.x + threadIdx.x;
    if (i >= NHT * 2049) return;
    const int h = i / 2049, n = i % 2049;
    int b;
    if (n < 16) b = n;
    else { b = 16 + (int)(log((double)n / 16.0) / log(128.0) * 16.0); if (b > 31) b = 31; }
    biasT[h * BT + n] = rel_bias[b * NHT + h];
}

__global__ __launch_bounds__(256) void sk_rmsnorm(const float* __restrict__ in, const float* __restrict__ g, float* __restrict__ out, int R) {
    const int row = (blockIdx.x * 256 + threadIdx.x) >> 6, lane = threadIdx.x & 63;
    if (row >= R) return;
    const f32x4* x = (const f32x4*)(in + (size_t)row * D) + lane;
    f32x4 v[4]; float s = 0.f;
#pragma unroll
    for (int j = 0; j < 4; ++j) { v[j] = x[64 * j]; s += v[j].x * v[j].x + v[j].y * v[j].y + v[j].z * v[j].z + v[j].w * v[j].w; }
    const float rs = 1.0f / sqrtf(wave_sum(s) * (1.0f / D) + EPS);
    f32x4* o = (f32x4*)(out + (size_t)row * D) + lane;
#pragma unroll
    for (int j = 0; j < 4; ++j) { const f32x4 gg = ((const f32x4*)g)[lane + 64 * j]; o[64 * j] = v[j] * rs * gg; }
}

template <int MODE>
__global__ __launch_bounds__(256) void sk_resid_norm(float* __restrict__ h, const float* __restrict__ f, const float* __restrict__ e, const float* __restrict__ g, float coef, int R) {
    const int row = (blockIdx.x * 256 + threadIdx.x) >> 6, lane = threadIdx.x & 63;
    if (row >= R) return;
    const f32x4* x = (const f32x4*)(f + (size_t)row * D) + lane;
    f32x4 v[4]; float s = 0.f;
#pragma unroll
    for (int j = 0; j < 4; ++j) {
        v[j] = x[64 * j];
        if (MODE == 1) { const f32x4 ev = ((const f32x4*)(e + (size_t)row * D) + lane)[64 * j];
            v[j].x = ev.x / (1.0f + expf(-v[j].x)); v[j].y = ev.y / (1.0f + expf(-v[j].y)); v[j].z = ev.z / (1.0f + expf(-v[j].z)); v[j].w = ev.w / (1.0f + expf(-v[j].w)); }
        s += v[j].x * v[j].x + v[j].y * v[j].y + v[j].z * v[j].z + v[j].w * v[j].w; }
    const float rs = 1.0f / sqrtf(wave_sum(s) * (1.0f / D) + EPS);
    f32x4* o = (f32x4*)(h + (size_t)row * D) + lane;
#pragma unroll
    for (int j = 0; j < 4; ++j) { const f32x4 gg = ((const f32x4*)g)[lane + 64 * j]; o[64 * j] = o[64 * j] + coef * (v[j] * rs * gg); }
}

__global__ void sk_swiglu(const float* __restrict__ gu, float* __restrict__ act, int R) {
    const size_t i = (size_t)blockIdx.x * blockDim.x + threadIdx.x;
    if (i >= (size_t)R * DFF) return;
    const size_t r = i / DFF, j = i % DFF;
    const float gv = gu[r * 2 * DFF + j], uv = gu[r * 2 * DFF + DFF + j];
    act[i] = gv / (1.0f + expf(-gv)) * uv;
}

__global__ __launch_bounds__(256) void sk_gemm(const float* __restrict__ A, int lda, const float* __restrict__ W, int ldw, const float* __restrict__ bias, float* __restrict__ C, int ldc, int K) {
    __shared__ float As[16][68];
    __shared__ float Ws[16][68];
    const int tid = threadIdx.x, tx = tid & 15, ty = tid >> 4;
    const int m0 = blockIdx.y * 64, n0 = blockIdx.x * 64;
    float acc[4][4];
#pragma unroll
    for (int i = 0; i < 4; ++i)
#pragma unroll
        for (int j = 0; j < 4; ++j) acc[i][j] = 0.f;
    const int ar = tid >> 2, ac = (tid & 3) * 4;
    const int wr = tid >> 4, wc = (tid & 15) * 4;
    for (int k0 = 0; k0 < K; k0 += 16) {
        const f32x4 av = *(const f32x4*)(A + (size_t)(m0 + ar) * lda + k0 + ac);
        const f32x4 wv = *(const f32x4*)(W + (size_t)(k0 + wr) * ldw + n0 + wc);
        __syncthreads();
        As[ac + 0][ar] = av.x; As[ac + 1][ar] = av.y; As[ac + 2][ar] = av.z; As[ac + 3][ar] = av.w;
        *(f32x4*)&Ws[wr][wc] = wv;
        __syncthreads();
#pragma unroll
        for (int k = 0; k < 16; ++k) {
            const f32x4 a = *(const f32x4*)&As[k][ty * 4];
            const f32x4 b = *(const f32x4*)&Ws[k][tx * 4];
            const float aa[4] = {a.x, a.y, a.z, a.w}, bb[4] = {b.x, b.y, b.z, b.w};
#pragma unroll
            for (int i = 0; i < 4; ++i)
#pragma unroll
                for (int j = 0; j < 4; ++j) acc[i][j] = fmaf(aa[i], bb[j], acc[i][j]);
        }
    }
    f32x4 bv = {0.f, 0.f, 0.f, 0.f};
    if (bias) bv = *(const f32x4*)(bias + n0 + tx * 4);
#pragma unroll
    for (int i = 0; i < 4; ++i) {
        f32x4 o = {acc[i][0] + bv.x, acc[i][1] + bv.y, acc[i][2] + bv.z, acc[i][3] + bv.w};
        *(f32x4*)(C + (size_t)(m0 + ty * 4 + i) * ldc + n0 + tx * 4) = o;
    }
}

__global__ __launch_bounds__(256) void sk_attn(const float* __restrict__ z, const float* __restrict__ biasT, const float* __restrict__ sinks, float* __restrict__ mix) {
    const int wave = (blockIdx.x * 256 + threadIdx.x) >> 6, lane = threadIdx.x & 63;
    const int t = wave >> 4, hh = wave & 15;
    if (t >= SEQ) return;
    if (hh < 8) {
        const int kvh = hh >> 2;
        const float q = z[(size_t)t * DIN + hh * 64 + lane];
        const float* kb = z + AQ + kvh * 64 + lane;
        const float* vb = z + AQ + AKV + kvh * 64 + lane;
        float m = -1e30f, s = 0.f, o = 0.f;
        for (int j = 0; j < 128; ++j) {
            const int tk = t - j; if (tk < 0) break;
            const float dot = wave_sum(q * kb[(size_t)tk * DIN]);
            const float logit = dot * 0.125f + biasT[hh * BT + j];
            const float mn = fmaxf(m, logit), a = expf(m - mn), p = expf(logit - mn);
            s = s * a + p; o = o * a + p * vb[(size_t)tk * DIN]; m = mn;
        }
        const float sink = sinks[hh];
        const float m_all = fmaxf(m, sink), scale = expf(m - m_all), total = s * scale + expf(sink - m_all);
        mix[(size_t)t * DMIX + hh * 64 + lane] = o * (scale / total);
    } else {
        const int hb = hh - 8;
        const float q = z[(size_t)t * DIN + 768 + hb * 64 + lane];
        const float* kb = z + 768 + BW + hb * 64 + lane;
        const float* vb = z + 768 + 2 * BW + hb * 64 + lane;
        float mi[3], si[3], oi[3];
#pragma unroll
        for (int br = 0; br < 3; ++br) {
            const int dil = br == 0 ? 1 : (br == 1 ? 4 : 16);
            float m = -1e30f, s = 0.f, o = 0.f;
            for (int j = 0; j <= 128; ++j) {
                const int tk = t - j * dil; if (tk < 0) break;
                const float dot = wave_sum(q * kb[(size_t)tk * DIN]);
                const float logit = dot * 0.125f + biasT[hh * BT + j * dil];
                const float mn = fmaxf(m, logit), a = expf(m - mn), p = expf(logit - mn);
                s = s * a + p; o = o * a + p * vb[(size_t)tk * DIN]; m = mn;
            }
            mi[br] = m; si[br] = s; oi[br] = o;
        }
        const float m_all = fmaxf(fmaxf(mi[0], mi[1]), mi[2]);
        const float w0 = expf(mi[0] - m_all), w1 = expf(mi[1] - m_all), w2 = expf(mi[2] - m_all);
        const float num = w0 * oi[0] + w1 * oi[1] + w2 * oi[2], den = w0 * si[0] + w1 * si[1] + w2 * si[2];
        mix[(size_t)t * DMIX + 512 + hb * 64 + lane] = num / den;
    }
}

enum { I_X = 0, I_P, I_RELB, I_F1PRE, I_F1GU, I_F1DN, I_F1POST, I_APRE, I_WIN, I_BIN, I_SINKS, I_WOUT, I_BOUT, I_APOST, I_F2PRE, I_F2GU, I_F2DN, I_F2POST, I_PPRE, I_WGATE, I_WPLE, I_PPOST, N_IN };

static void gemm(hipStream_t s, const float* A, int lda, const float* W, int ldw, const float* bias, float* C, int ldc, int R, int N, int K) {
    hipLaunchKernelGGL(sk_gemm, dim3(N / 64, R / 64), dim3(256), 0, s, A, lda, W, ldw, bias, C, ldc, K);
}

extern "C" void kernel_launch(void* const* d_in, const int* in_sizes, int n_in, void* d_out, int out_size, void* d_ws, size_t ws_size, hipStream_t stream) {
    if (n_in != N_IN || out_size != M * D) { fprintf(stderr, "kernel_launch: unexpected shapes (n_in %d, out %d)\n", n_in, out_size); return; }
    const float* in[N_IN]; for (int i = 0; i < N_IN; ++i) in[i] = (const float*)d_in[i];
    float* out = (float*)d_out;
    char* ws = (char*)d_ws;
    constexpr size_t MiB = 1u << 20;
    float* biasT = (float*)(ws + 0);
    float* XN  = (float*)(ws + 1 * MiB);
    float* GU  = (float*)(ws + 17 * MiB);
    float* ACT = (float*)(ws + 105 * MiB);
    float* F   = (float*)(ws + 149 * MiB);
    float* Z   = (float*)(ws + 165 * MiB);
    float* MIX = (float*)(ws + 201 * MiB);
    float* G   = (float*)(ws + 217 * MiB);
    float* E   = (float*)(ws + 233 * MiB);
    hipMemcpyAsync(out, in[I_X], (size_t)M * D * 4, hipMemcpyDeviceToDevice, stream);
    hipLaunchKernelGGL(sk_bias_table, dim3((NHT * 2049 + 255) / 256), dim3(256), 0, stream, in[I_RELB], biasT);
    const int R = SEQ, NB_ROWS = R / 4;
    for (int b = 0; b < BATCH; ++b) {
        float* h = out + (size_t)b * SEQ * D;
        for (int f = 0; f < 2; ++f) {
            if (f == 1) {
                hipLaunchKernelGGL(sk_rmsnorm, dim3(NB_ROWS), dim3(256), 0, stream, (const float*)h, in[I_APRE], XN, R);
                gemm(stream, XN, D, in[I_WIN], DIN, in[I_BIN], Z, DIN, R, DIN, D);
                hipLaunchKernelGGL(sk_attn, dim3(SEQ * 16 / 4), dim3(256), 0, stream, (const float*)Z, (const float*)biasT, in[I_SINKS], MIX);
                gemm(stream, MIX, DMIX, in[I_WOUT], D, in[I_BOUT], F, D, R, D, DMIX);
                hipLaunchKernelGGL(sk_resid_norm<0>, dim3(NB_ROWS), dim3(256), 0, stream, h, (const float*)F, (const float*)nullptr, in[I_APOST], 1.0f, R);
            }
            const float* pre = in[f ? I_F2PRE : I_F1PRE]; const float* wgu = in[f ? I_F2GU : I_F1GU]; const float* wdn = in[f ? I_F2DN : I_F1DN]; const float* post = in[f ? I_F2POST : I_F1POST];
            hipLaunchKernelGGL(sk_rmsnorm, dim3(NB_ROWS), dim3(256), 0, stream, (const float*)h, pre, XN, R);
            gemm(stream, XN, D, wgu, 2 * DFF, nullptr, GU, 2 * DFF, R, 2 * DFF, D);
            hipLaunchKernelGGL(sk_swiglu, dim3((unsigned)(((size_t)R * DFF + 255) / 256)), dim3(256), 0, stream, (const float*)GU, ACT, R);
            gemm(stream, ACT, DFF, wdn, D, nullptr, F, D, R, D, DFF);
            hipLaunchKernelGGL(sk_resid_norm<0>, dim3(NB_ROWS), dim3(256), 0, stream, h, (const float*)F, (const float*)nullptr, post, 0.5f, R);
        }
        hipLaunchKernelGGL(sk_rmsnorm, dim3(NB_ROWS), dim3(256), 0, stream, (const float*)h, in[I_PPRE], XN, R);
        gemm(stream, XN, D, in[I_WGATE], D, nullptr, G, D, R, D, D);
        gemm(stream, in[I_P] + (size_t)b * SEQ * PLE, PLE, in[I_WPLE], D, nullptr, E, D, R, D, PLE);
        hipLaunchKernelGGL(sk_resid_norm<1>, dim3(NB_ROWS), dim3(256), 0, stream, h, (const float*)G, (const float*)E, in[I_PPOST], 1.0f, R);
    }
}
```
